# Optimizing an MI355X kernel written in HIP

```python
import jax, jax.numpy as jnp
from jax import lax
import numpy as np

D_MODEL = 1024
BATCH = 2
SEQ = 16384
DEPTH = 2
DEC_BATCH = 8
DEC_SEQ = 8192
PAST_LEN = 128

N_MIXERS = 2
N_FNET_LAYERS = (DEPTH + 1) // 2
N_CONV_LAYERS = DEPTH // 2
D_MIX = D_MODEL
FNET_GROUPS = 8
FNET_GROUP_DIM = D_MIX // FNET_GROUPS
CONV_WIDTH = 3
D_FF = 2816
N_FFN_PER_LAYER = 2
N_LN_PER_LAYER = 3
ALPHA = float((2 * DEPTH) ** 0.25)
BETA = float((8 * DEPTH) ** -0.25)
LN_EPS = 1e-5

kernel_name = "hybrid_fnet_shortconv_macaron_encoder"


def layer_norm(x, g, b):
    xf = x.astype(jnp.float32)
    mu = jnp.mean(xf, axis=-1, keepdims=True)
    var = jnp.mean(jnp.square(xf - mu), axis=-1, keepdims=True)
    y = (xf - mu) * lax.rsqrt(var + LN_EPS) * g.astype(jnp.float32) + b.astype(jnp.float32)
    return y.astype(x.dtype)


def swiglu_ffn(x, w_gate, w_up, w_down):
    h = jax.nn.silu(jnp.einsum("bsd,df->bsf", x, w_gate)) * jnp.einsum("bsd,df->bsf", x, w_up)
    return jnp.einsum("bsf,fd->bsd", h, w_down)


def fourier_mixer(x, w_in, w_out):
    bsz, s, _ = x.shape
    u = jnp.einsum("bsd,de->bse", x, w_in).reshape(bsz, s, FNET_GROUPS, FNET_GROUP_DIM)
    f = jnp.fft.fft2(u.astype(jnp.float32), axes=(1, 3), norm="ortho").real
    f = f.reshape(bsz, s, D_MIX).astype(x.dtype)
    return jnp.einsum("bse,ed->bsd", f, w_out)


def centred_depthwise_conv(u, w):
    up = jnp.pad(u, ((0, 0), (1, 1), (0, 0)))
    return up[:, :-2] * w[0] + up[:, 1:-1] * w[1] + up[:, 2:] * w[2]


def short_conv_mixer(x, w_in, w_conv, w_out):
    proj = jnp.einsum("bsd,de->bse", x, w_in)
    gate_b, gate_c, h = jnp.split(proj, 3, axis=-1)
    y = gate_b * centred_depthwise_conv(gate_c * h, w_conv)
    return jnp.einsum("bse,ed->bsd", y, w_out)


def trunk(x, ffn_w_gate, ffn_w_up, ffn_w_down, ln_g, ln_b,
          fnet_w_in, fnet_w_out, conv_w_in, conv_w, conv_w_out):
    for i in range(DEPTH):
        x = layer_norm(ALPHA * x + 0.5 * swiglu_ffn(x, ffn_w_gate[i, 0], ffn_w_up[i, 0], ffn_w_down[i, 0]),
                       ln_g[i, 0], ln_b[i, 0])
        j = i // N_MIXERS
        if i % N_MIXERS == 0:
            m = fourier_mixer(x, fnet_w_in[j], fnet_w_out[j])
        else:
            m = short_conv_mixer(x, conv_w_in[j], conv_w[j], conv_w_out[j])
        x = layer_norm(ALPHA * x + m, ln_g[i, 1], ln_b[i, 1])
        x = layer_norm(ALPHA * x + 0.5 * swiglu_ffn(x, ffn_w_gate[i, 1], ffn_w_up[i, 1], ffn_w_down[i, 1]),
                       ln_g[i, 2], ln_b[i, 2])
    return x


def setup_inputs(seed: int = 0) -> dict:
    key = jax.random.key(seed)
    ks = jax.random.split(key, 13)
    f32 = jnp.float32
    d_in = D_MODEL ** -0.5
    return {
        "x_prompt": jax.random.normal(ks[0], (BATCH, SEQ, D_MODEL), f32),
        "x_sample": jax.random.normal(ks[1], (DEC_BATCH, DEC_SEQ, D_MODEL), f32),
        "ffn_w_gate": jax.random.normal(ks[2], (DEPTH, N_FFN_PER_LAYER, D_MODEL, D_FF), f32) * d_in,
        "ffn_w_up": jax.random.normal(ks[3], (DEPTH, N_FFN_PER_LAYER, D_MODEL, D_FF), f32) * d_in,
        "ffn_w_down": jax.random.normal(ks[4], (DEPTH, N_FFN_PER_LAYER, D_FF, D_MODEL), f32) * (D_FF ** -0.5 * BETA),
        "ln_g": 1.0 + 0.02 * jax.random.normal(ks[5], (DEPTH, N_LN_PER_LAYER, D_MODEL), f32),
        "ln_b": 0.02 * jax.random.normal(ks[6], (DEPTH, N_LN_PER_LAYER, D_MODEL), f32),
        "fnet_w_in": jax.random.normal(ks[7], (N_FNET_LAYERS, D_MODEL, D_MIX), f32) * d_in,
        "fnet_w_out": jax.random.normal(ks[8], (N_FNET_LAYERS, D_MIX, D_MODEL), f32) * (D_MIX ** -0.5 * BETA),
        "conv_w_in": jax.random.normal(ks[9], (N_CONV_LAYERS, D_MODEL, 3 * D_MIX), f32) * d_in,
        "conv_w": jax.random.normal(ks[10], (N_CONV_LAYERS, CONV_WIDTH, D_MIX), f32) * (CONV_WIDTH ** -0.5),
        "conv_w_out": jax.random.normal(ks[11], (N_CONV_LAYERS, D_MIX, D_MODEL), f32) * (D_MIX ** -0.5 * BETA),
    }


def reference(x_prompt, x_sample, ffn_w_gate, ffn_w_up, ffn_w_down, ln_g, ln_b,
              fnet_w_in, fnet_w_out, conv_w_in, conv_w, conv_w_out):
    y_prompt = trunk(x_prompt, ffn_w_gate, ffn_w_up, ffn_w_down, ln_g, ln_b,
                     fnet_w_in, fnet_w_out, conv_w_in, conv_w, conv_w_out)
    y_sample = trunk(x_sample, ffn_w_gate, ffn_w_up, ffn_w_down, ln_g, ln_b,
                     fnet_w_in, fnet_w_out, conv_w_in, conv_w, conv_w_out)
    return (y_prompt, y_sample)
```

```cpp
#include <hip/hip_runtime.h>
#include <hip/hip_cooperative_groups.h>
#include <cstdio>
namespace cg = cooperative_groups;

#ifndef MK_COOP
#define MK_COOP 1
#endif

#define LAS __attribute__((address_space(3)))
typedef unsigned short bf16_t;
typedef short bf16x8 __attribute__((ext_vector_type(8)));
typedef float f32x4 __attribute__((ext_vector_type(4)));
typedef float f32x2 __attribute__((ext_vector_type(2)));
typedef unsigned u32x4 __attribute__((ext_vector_type(4)));
typedef unsigned u32x2 __attribute__((ext_vector_type(2)));

constexpr int DM = 1024, DFF = 2816, TP = 32768  , TS = 65536  , T = TP + TS;
constexpr float ALPHA = 1.41421356237f;
constexpr float LN_EPS = 1e-5f;
constexpr int NPH = 22;

constexpr size_t MiB = 1024 * 1024;
constexpr size_t WS_ONES = 0, WS_ZEROS = 4096, WS_STATS = 8192;
constexpr size_t WS_TWPC = WS_STATS + (size_t)T * 8, WS_TWPS = WS_TWPC + 65536, WS_TWSC = WS_TWPS + 65536, WS_TWSS = WS_TWSC + 32768;
constexpr size_t WS_F1 = WS_TWSS + 32768, WS_F3P = WS_F1 + 131072, WS_F3S = WS_F3P + 131072;
constexpr size_t WS_WGU = 2 * MiB;
constexpr size_t WS_WD = WS_WGU + 4ull * 5632 * 1024 * 2;
constexpr size_t WS_WY = WS_WD + 4ull * 1024 * 2816 * 2;
constexpr size_t WS_WFO = WS_WY + 2048ull * 1024 * 2, WS_WCI = WS_WFO + 1024ull * 1024 * 2, WS_WCO = WS_WCI + 3072ull * 1024 * 2;
constexpr size_t WS_R = 84 * MiB;
constexpr size_t WS_END = WS_R + 768 * MiB;
static_assert(WS_WCO + 1024ull * 1024 * 2 <= WS_R, "weights overflow");
static_assert(WS_F3S + 131072 <= WS_WGU, "tables overflow");
constexpr size_t R_H = 0, R_XB = 576 * MiB, R_D = 0, R_E = 384 * MiB, R_F = 0, R_V = 0, R_G = 192 * MiB, R_Y = 384 * MiB;
constexpr size_t ES_BASE = 67108864;

__device__ __forceinline__ unsigned cvt_pk_bf16(float lo, float hi) { unsigned r; asm volatile("v_cvt_pk_bf16_f32 %0, %1, %2" : "=v"(r) : "v"(lo), "v"(hi)); return r; }
__device__ __forceinline__ u32x4 pack8(const f32x4 a, const f32x4 b) { u32x4 w; w.x = cvt_pk_bf16(a[0], a[1]); w.y = cvt_pk_bf16(a[2], a[3]); w.z = cvt_pk_bf16(b[0], b[1]); w.w = cvt_pk_bf16(b[2], b[3]); return w; }
__device__ __forceinline__ float bf_lo(unsigned w) { return __uint_as_float(w << 16); }
__device__ __forceinline__ float bf_hi(unsigned w) { return __uint_as_float(w & 0xffff0000u); }

namespace pg8 {
constexpr int BM = 256, BK = 64, HALF = 128, HTB = HALF * BK * 2, STAGE_BYTES = 8 * HTB, NXCD = 8, WGM = 8;
__device__ __forceinline__ int lds_byte(int r, int c) { const int st = (r >> 4) * 2 + (c >> 5), rr = r & 15, cc = c & 31, ob = rr * 64 + cc * 2; return st * 1024 + (ob ^ (((ob >> 9) & 1) << 5)); }
__device__ __forceinline__ void stage_rc(int b, int& R, int& C) { const int st = b / 1024, sb = b % 1024, swz = sb ^ (((sb >> 9) & 1) << 5); R = (st >> 1) * 16 + swz / 64; C = (st & 1) * 32 + (swz % 64) / 2; }
__device__ __forceinline__ int perm32(int rho) { const int n = rho >> 4, i = rho & 15; return 8 * (i >> 2) + 4 * n + (i & 3); }
struct Unit { int pm, pn; };
struct Gemm { const bf16_t* A; const bf16_t* Bt; int M, N, K; };
struct StaticOrder {
    int nM, nN, nwg, G, c;
    __device__ void init(int M, int N, int G_, int c_) { nM = M / BM; nN = N / BM; nwg = nM * nN; G = G_; c = c_; }
    __device__ bool next(int i, Unit& u) const {
        const long L = (long)i * G + c; if (L >= nwg) return false;
        int wgid = (int)L; { const int q = nwg / NXCD, r = nwg % NXCD, xcd = wgid % NXCD, off = wgid / NXCD; wgid = (xcd < r ? xcd * (q + 1) : r * (q + 1) + (xcd - r) * q) + off; }
        const int nig = WGM * nN, gid = wgid / nig, fm = gid * WGM, gsz = (nM - fm) < WGM ? (nM - fm) : WGM;
        u.pm = fm + ((wgid % nig) % gsz); u.pn = (wgid % nig) / gsz; return true;
    }
};

template <class Epi>
__device__ __forceinline__ void gemm_phase(LAS unsigned char* lds, const Gemm g, const StaticOrder& S, const Epi& E, const int tid) {
    const int wid = __builtin_amdgcn_readfirstlane(tid >> 6), lane = tid & 63, wr = wid >> 2, wc = wid & 3, fr = lane & 15, fq = lane >> 4;
    const int K = g.K, nt = K / BK;
    unsigned voffA[2], voffB[2];
#pragma unroll
    for (int i = 0; i < 2; ++i) { int R, C; stage_rc(tid * 16 + i * 8192, R, C); const int Rb = Epi::PERM ? ((R & ~31) + perm32(R & 31)) : R;
        voffA[i] = (unsigned)(R * K + C) * 2u; voffB[i] = (unsigned)(Rb * K + C) * 2u; }
    const size_t kstep = (size_t)(BK * 2);
    const size_t hstep = (size_t)HALF * K * 2;
    const size_t tstep = 2 * hstep;
    const unsigned ldsw = (unsigned)wid * 1024u;
    const int aoff = lds_byte(wr * 64 + fr, fq * 8), boff = lds_byte(wc * 32 + fr, fq * 8);
#define PG8_SA(b, h) (((b) * 2 + (h)) * HTB)
#define PG8_SB(b, h) ((4 + (b) * 2 + (h)) * HTB)
#define PG8_STAGE(bufoff, gbase, voff) do { _Pragma("unroll") for (int _i = 0; _i < 2; ++_i) \
        __builtin_amdgcn_global_load_lds((const unsigned*)((const char*)(gbase) + (voff)[_i]), (LAS unsigned*)(lds + (bufoff) + ldsw + _i * 8192), 16, 0, 0); } while (0)
#define PG8_LDA(dst, b, h) do { _Pragma("unroll") for (int m = 0; m < 4; ++m) _Pragma("unroll") for (int k = 0; k < 2; ++k) dst[m][k] = *(const LAS bf16x8*)(lds + PG8_SA(b, h) + aoff + m * 2048 + k * 1024); } while (0)
#define PG8_LDB(dst, b, h) do { _Pragma("unroll") for (int n = 0; n < 2; ++n) _Pragma("unroll") for (int k = 0; k < 2; ++k) dst[n][k] = *(const LAS bf16x8*)(lds + PG8_SB(b, h) + boff + n * 2048 + k * 1024); } while (0)
#define PG8_MMA(ai, bj, At, Bt) do { __builtin_amdgcn_s_setprio(1); _Pragma("unroll") for (int m = 0; m < 4; ++m) _Pragma("unroll") for (int n = 0; n < 2; ++n) _Pragma("unroll") for (int k = 0; k < 2; ++k) \
        acc[ai][bj][m][n] = __builtin_amdgcn_mfma_f32_16x16x32_bf16(Bt[n][k], At[m][k], acc[ai][bj][m][n], 0, 0, 0); __builtin_amdgcn_s_setprio(0); } while (0)
#define PG8_WAIT_V(n) asm volatile("s_waitcnt vmcnt(" #n ")" ::: "memory")
#define PG8_WAIT_L(n) asm volatile("s_waitcnt lgkmcnt(" #n ")" ::: "memory")
#define PG8_BAR __builtin_amdgcn_s_barrier()
#define PG8_SCHED __builtin_amdgcn_sched_barrier(0)
    Unit cur, nxt; int ui = 0;
    if (!S.next(0, cur)) return;
    f32x4 acc[2][2][4][2];
#pragma unroll
    for (int a = 0; a < 2; ++a)
#pragma unroll
        for (int b = 0; b < 2; ++b)
#pragma unroll
            for (int m = 0; m < 4; ++m)
#pragma unroll
                for (int n = 0; n < 2; ++n) acc[a][b][m][n] = (f32x4){0.f, 0.f, 0.f, 0.f};
    bf16x8 At[4][2], B0[2][2], B1[2][2];
    const char* cA = (const char*)g.A + (size_t)cur.pm * tstep; const char* cB = (const char*)g.Bt + (size_t)cur.pn * tstep;
    PG8_STAGE(PG8_SB(0, 0), cB, voffB); PG8_STAGE(PG8_SA(0, 0), cA, voffA); PG8_STAGE(PG8_SB(0, 1), cB + hstep, voffB); PG8_STAGE(PG8_SA(0, 1), cA + hstep, voffA);
    if (wr == 1) PG8_BAR;
    PG8_WAIT_V(4); PG8_BAR;
    PG8_STAGE(PG8_SB(1, 0), cB + kstep, voffB); PG8_STAGE(PG8_SA(1, 0), cA + kstep, voffA); PG8_STAGE(PG8_SB(1, 1), cB + hstep + kstep, voffB);
    PG8_WAIT_V(6); PG8_BAR;
    for (;;) {
        const bool has_next = S.next(ui + 1, nxt);
        const char* nA = has_next ? (const char*)g.A + (size_t)nxt.pm * tstep : cA; const char* nB = has_next ? (const char*)g.Bt + (size_t)nxt.pn * tstep : cB;
#pragma unroll 1
        for (int t = 0; t < nt; t += 2) {
            const bool last = (t == nt - 2);
            const char* a1 = cA + (size_t)(t + 1) * kstep;
            const char* a2 = last ? nA : cA + (size_t)(t + 2) * kstep; const char* b2 = last ? nB : cB + (size_t)(t + 2) * kstep;
            const char* a3 = a2 + kstep; const char* b3 = b2 + kstep;
            PG8_LDB(B0, 0, 0); PG8_SCHED; PG8_LDA(At, 0, 0); PG8_STAGE(PG8_SA(1, 1), a1 + hstep, voffA);
            PG8_WAIT_L(8); PG8_BAR; PG8_WAIT_L(0); PG8_MMA(0, 0, At, B0); PG8_BAR; PG8_SCHED;
            PG8_LDB(B1, 0, 1); PG8_STAGE(PG8_SB(0, 0), b2, voffB);
            PG8_BAR; PG8_WAIT_L(0); PG8_MMA(0, 1, At, B1); PG8_BAR;
            PG8_LDA(At, 0, 1); PG8_STAGE(PG8_SA(0, 0), a2, voffA);
            PG8_BAR; PG8_WAIT_L(0); PG8_MMA(1, 0, At, B0); PG8_BAR; PG8_SCHED;
            PG8_STAGE(PG8_SB(0, 1), b2 + hstep, voffB);
            PG8_WAIT_V(6); PG8_BAR; PG8_MMA(1, 1, At, B1); PG8_BAR;
            PG8_LDB(B0, 1, 0); PG8_SCHED; PG8_LDA(At, 1, 0); PG8_STAGE(PG8_SA(0, 1), a2 + hstep, voffA);
            PG8_WAIT_L(8); PG8_BAR; PG8_WAIT_L(0); PG8_MMA(0, 0, At, B0); PG8_BAR; PG8_SCHED;
            PG8_LDB(B1, 1, 1); PG8_STAGE(PG8_SB(1, 0), b3, voffB);
            PG8_BAR; PG8_WAIT_L(0); PG8_MMA(0, 1, At, B1); PG8_BAR;
            PG8_LDA(At, 1, 1); PG8_STAGE(PG8_SA(1, 0), a3, voffA);
            PG8_BAR; PG8_WAIT_L(0); PG8_MMA(1, 0, At, B0); PG8_BAR; PG8_SCHED;
            PG8_STAGE(PG8_SB(1, 1), b3 + hstep, voffB);
            PG8_WAIT_V(6); PG8_BAR; PG8_MMA(1, 1, At, B1); PG8_BAR;
        }
        { int fr_ = fr, fq_ = fq, wr_ = wr, wc_ = wc; asm volatile("" : "+v"(fr_), "+v"(fq_), "+s"(wr_), "+s"(wc_));
          E(acc, cur, wr_, wc_, fr_, fq_); }
        if (!has_next) break;
#pragma unroll
        for (int a = 0; a < 2; ++a)
#pragma unroll
            for (int b = 0; b < 2; ++b)
#pragma unroll
                for (int m = 0; m < 4; ++m)
#pragma unroll
                    for (int n = 0; n < 2; ++n) acc[a][b][m][n] = (f32x4){0.f, 0.f, 0.f, 0.f};
        cur = nxt; cA = nA; cB = nB; ++ui;
    }
    PG8_WAIT_V(0);
    if (wr == 0) PG8_BAR;
    PG8_BAR;
#undef PG8_SA
#undef PG8_SB
#undef PG8_STAGE
#undef PG8_LDA
#undef PG8_LDB
#undef PG8_MMA
#undef PG8_WAIT_V
#undef PG8_WAIT_L
#undef PG8_BAR
#undef PG8_SCHED
}
}
using pg8::Unit;

__device__ __forceinline__ float silu_f(float g) { return g * __builtin_amdgcn_rcpf(1.0f + __expf(-g)); }

struct EpiGU {
    static constexpr bool PERM = true;
    bf16_t* H;
    __device__ __forceinline__ void operator()(const f32x4 (&acc)[2][2][4][2], const Unit& u, int wr, int wc, int fr, int fq) const {
        const int row0 = u.pm * 256 + wr * 64 + fr, col0 = u.pn * 128 + wc * 32 + 8 * fq;
#pragma unroll
        for (int ai = 0; ai < 2; ++ai)
#pragma unroll
            for (int m = 0; m < 4; ++m) {
                f32x4 h0, h1;
#pragma unroll
                for (int j = 0; j < 4; ++j) { h0[j] = silu_f(acc[ai][0][m][0][j]) * acc[ai][1][m][0][j]; h1[j] = silu_f(acc[ai][0][m][1][j]) * acc[ai][1][m][1][j]; }
                *(u32x4*)(H + (size_t)(row0 + ai * 128 + m * 16) * DFF + col0) = pack8(h0, h1);
            }
    }
};

struct EpiRes {
    static constexpr bool PERM = false;
    const float* zin0; const float* zin1; float* zout; const f32x2* stats; const float* gam; const float* bet; float scale;
    __device__ __forceinline__ void operator()(const f32x4 (&acc)[2][2][4][2], const Unit& u, int wr, int wc, int fr, int fq) const {
        const int row0 = u.pm * 256 + wr * 64 + fr, col0 = u.pn * 256 + wc * 32 + 4 * fq;
        const float* zi = (u.pm < 128) ? zin0 + (size_t)row0 * DM : zin1 + (size_t)(row0 - TP) * DM;
        float* zo = zout + (size_t)row0 * DM;
        f32x2 st[2][4];
#pragma unroll
        for (int ai = 0; ai < 2; ++ai)
#pragma unroll
            for (int m = 0; m < 4; ++m) st[ai][m] = stats[row0 + ai * 128 + m * 16];
#pragma unroll
        for (int bj = 0; bj < 2; ++bj)
#pragma unroll
            for (int n = 0; n < 2; ++n) {
                const int c = col0 + bj * 128 + n * 16;
                const f32x4 g = *(const f32x4*)(gam + c) * ALPHA, b = *(const f32x4*)(bet + c) * ALPHA;
#pragma unroll
                for (int ai = 0; ai < 2; ++ai)
#pragma unroll
                    for (int m = 0; m < 4; ++m) {
                        const size_t off = (size_t)(ai * 128 + m * 16) * DM + c;
                        const f32x4 zv = *(const f32x4*)(zi + off);
                        const f32x4 o = (zv - st[ai][m].x) * st[ai][m].y * g + b + acc[ai][bj][m][n] * scale;
                        *(f32x4*)(zo + off) = o;
                    }
            }
    }
};

struct EpiD {
    static constexpr bool PERM = true;
    bf16_t* D;
    __device__ __forceinline__ void operator()(const f32x4 (&acc)[2][2][4][2], const Unit& u, int wr, int wc, int fr, int fq) const {
        const int n1 = wc * 32 + 8 * fq;
#pragma unroll
        for (int bj = 0; bj < 2; ++bj) {
            const int chunk = 2 * u.pn + bj; int rb, cs;
            if (chunk < 256) { const int b = chunk >> 7, n2 = chunk & 127; rb = b * 1024 * 128 + n2; cs = 128; }
            else { const int ch = chunk - 256, b = ch >> 6, n2 = ch & 63; rb = 262144 + b * 1024 * 64 + n2; cs = 64; }
#pragma unroll
            for (int ai = 0; ai < 2; ++ai)
#pragma unroll
                for (int m = 0; m < 4; ++m) {
                    const int i = u.pm * 256 + ai * 128 + wr * 64 + m * 16 + fr, ri = i >> 10, c = i & 1023;
                    *(u32x4*)(D + (size_t)(rb + c * cs) * 256 + ri * 128 + n1) = pack8(acc[ai][bj][m][0], acc[ai][bj][m][1]);
                }
        }
    }
};

struct EpiB1 {
    static constexpr bool PERM = true;
    bf16_t* E; const float* twpc; const float* twps; const float* twsc; const float* twss;
    __device__ __forceinline__ void operator()(const f32x4 (&acc)[2][2][4][2], const Unit& u, int wr, int wc, int fr, int fq) const {
        const bool pr = u.pn < 1024;
#pragma unroll
        for (int bj = 0; bj < 2; ++bj) {
            const int j0 = u.pn * 256 + bj * 128 + wc * 32 + 8 * fq;
            int bc, n2;
            if (pr) { bc = j0 >> 7; n2 = j0 & 127; } else { const int jj = j0 - 262144; bc = jj >> 6; n2 = jj & 63; }
            const int b = bc >> 10, c = bc & 1023;
#pragma unroll
            for (int m = 0; m < 4; ++m) {
                const int k1 = wr * 64 + m * 16 + fr;
                const float* tc = pr ? twpc : twsc; const float* ts = pr ? twps : twss;
                const unsigned two = pr ? (unsigned)(k1 * 128 + n2) : (unsigned)(k1 * 64 + n2);
                unsigned eoff; int istr;
                if (pr) { eoff = (unsigned)((b * 128 + k1) * 1024 + c) * 256u + n2; istr = 128; }
                else { eoff = (unsigned)ES_BASE + (unsigned)((b * 128 + k1) * 512 + (c & 511)) * 256u + (c >> 9) * 128 + n2; istr = 64; }
                u32x4 wr_, wi_;
                { const f32x4 c0 = *(const f32x4*)(tc + two), s0 = *(const f32x4*)(ts + two);
                  const f32x4 tr0 = acc[0][bj][m][0], ti0 = acc[1][bj][m][0];
                  const f32x4 er0 = tr0 * c0 + ti0 * s0, ei0 = ti0 * c0 - tr0 * s0;
                  wr_.x = cvt_pk_bf16(er0[0], er0[1]); wr_.y = cvt_pk_bf16(er0[2], er0[3]); wi_.x = cvt_pk_bf16(ei0[0], ei0[1]); wi_.y = cvt_pk_bf16(ei0[2], ei0[3]); }
                asm volatile("" ::: "memory");
                { const f32x4 c1 = *(const f32x4*)(tc + two + 4), s1 = *(const f32x4*)(ts + two + 4);
                  const f32x4 tr1 = acc[0][bj][m][1], ti1 = acc[1][bj][m][1];
                  const f32x4 er1 = tr1 * c1 + ti1 * s1, ei1 = ti1 * c1 - tr1 * s1;
                  wr_.z = cvt_pk_bf16(er1[0], er1[1]); wr_.w = cvt_pk_bf16(er1[2], er1[3]); wi_.z = cvt_pk_bf16(ei1[0], ei1[1]); wi_.w = cvt_pk_bf16(ei1[2], ei1[3]); }
                *(u32x4*)(E + eoff) = wr_;
                *(u32x4*)(E + eoff + istr) = wi_;
                asm volatile("" ::: "memory");
            }
        }
    }
};

struct EpiB3 {
    static constexpr bool PERM = true;
    bf16_t* F; int sample;
    __device__ __forceinline__ void operator()(const f32x4 (&acc)[2][2][4][2], const Unit& u, int wr, int wc, int fr, int fq) const {
#pragma unroll
        for (int bj = 0; bj < 2; ++bj) {
            const int j0 = u.pn * 256 + bj * 128 + wc * 32 + 8 * fq;
#pragma unroll
            for (int m = 0; m < 4; ++m) {
                int tok, col;
                if (!sample) { const int c = j0 & 1023, k1 = (j0 >> 10) & 127, b = j0 >> 17, k2 = wr * 64 + m * 16 + fr; tok = b * 16384 + k1 + 128 * k2; col = c; }
                else { const int ch = j0 & 511, k1 = (j0 >> 9) & 127, b = j0 >> 16, k2 = m * 16 + fr; tok = TP + b * 8192 + k1 + 128 * k2; col = wr * 512 + ch; }
                *(u32x4*)(F + (size_t)tok * DM + col) = pack8(acc[0][bj][m][0], acc[0][bj][m][1]);
            }
        }
    }
};

struct EpiCI {
    static constexpr bool PERM = true;
    bf16_t* V; bf16_t* G;
    __device__ __forceinline__ void operator()(const f32x4 (&acc)[2][2][4][2], const Unit& u, int wr, int wc, int fr, int fq) const {
        const int row0 = u.pm * 256 + wr * 64 + fr;
        if (u.pn < 8) {
            const int col = u.pn * 128 + wc * 32 + 8 * fq;
#pragma unroll
            for (int ai = 0; ai < 2; ++ai)
#pragma unroll
                for (int m = 0; m < 4; ++m)
                    *(u32x4*)(V + (size_t)(row0 + ai * 128 + m * 16) * DM + col) = pack8(acc[ai][0][m][0] * acc[ai][1][m][0], acc[ai][0][m][1] * acc[ai][1][m][1]);
        } else {
#pragma unroll
            for (int ai = 0; ai < 2; ++ai)
#pragma unroll
                for (int m = 0; m < 4; ++m)
#pragma unroll
                    for (int bj = 0; bj < 2; ++bj) {
                        const int col = (u.pn - 8) * 256 + bj * 128 + wc * 32 + 8 * fq;
                        *(u32x4*)(G + (size_t)(row0 + ai * 128 + m * 16) * DM + col) = pack8(acc[ai][bj][m][0], acc[ai][bj][m][1]);
                    }
        }
    }
};

struct Args { const float* in[12]; float* out; unsigned char* ws; int ph_lo, ph_hi; };

__device__ __forceinline__ float wave_sum(float v) {
#pragma unroll
    for (int o = 32; o >= 1; o >>= 1) v += __shfl_xor(v, o);
    return v;
}

__device__ __forceinline__ void ln_pass(float* z, f32x2* stats, const float* gam, const float* bet, bf16_t* xb, int permute, int fin, const int tid, const int cid) {
    const int lane = tid & 63, wave = tid >> 6;
    f32x4 g[4], b[4];
#pragma unroll
    for (int i = 0; i < 4; ++i) { g[i] = ((const f32x4*)gam)[lane + 64 * i]; b[i] = ((const f32x4*)bet)[lane + 64 * i]; }
    for (int row = cid * 8 + wave; row < T; row += gridDim.x * 8) {
        f32x4* zr = (f32x4*)(z + (size_t)row * DM);
        f32x4 v[4];
#pragma unroll
        for (int i = 0; i < 4; ++i) v[i] = zr[lane + 64 * i];
        float s = 0.f;
#pragma unroll
        for (int i = 0; i < 4; ++i) s += (v[i][0] + v[i][1]) + (v[i][2] + v[i][3]);
        const float mean = wave_sum(s) * (1.0f / DM);
        float q = 0.f;
#pragma unroll
        for (int i = 0; i < 4; ++i) { const f32x4 d = v[i] - mean; q += (d[0] * d[0] + d[1] * d[1]) + (d[2] * d[2] + d[3] * d[3]); }
        const float rstd = 1.0f / sqrtf(wave_sum(q) * (1.0f / DM) + LN_EPS);
        if (fin) {
#pragma unroll
            for (int i = 0; i < 4; ++i) zr[lane + 64 * i] = (v[i] - mean) * rstd * g[i] + b[i];
        } else {
            if (lane == 0) stats[row] = (f32x2){mean, rstd};
            int j = row;
            if (permute) {
                if (row < TP) { const int bb = row >> 14, s_ = row & 16383, n1 = s_ >> 7, n2 = s_ & 127; j = (bb * 128 + n2) * 128 + n1; }
                else { const int t_ = row - TP, bb = t_ >> 13, s_ = t_ & 8191, n1 = s_ >> 6, n2 = s_ & 63; j = TP + (bb * 64 + n2) * 128 + n1; }
            }
            u32x2* xr = (u32x2*)(xb + (size_t)j * DM);
#pragma unroll
            for (int i = 0; i < 4; ++i) { const f32x4 y = (v[i] - mean) * rstd * g[i] + b[i]; u32x2 w; w.x = cvt_pk_bf16(y[0], y[1]); w.y = cvt_pk_bf16(y[2], y[3]); xr[lane + 64 * i] = w; }
        }
    }
}

__device__ __forceinline__ void conv_pass(const bf16_t* V, const bf16_t* G, const float* cw, bf16_t* Y, const int tid, const int cid) {
    const size_t gsz = (size_t)gridDim.x * 512;
    for (size_t it = (size_t)cid * 512 + tid; it < (size_t)T * 128; it += gsz) {
        const int t = (int)(it >> 7), c = (int)(it & 127) * 8;
        int pos, len; if (t < TP) { pos = t & 16383; len = 16384; } else { pos = (t - TP) & 8191; len = 8192; }
        const size_t o = (size_t)t * DM + c;
        const u32x4 vc = *(const u32x4*)(V + o), gb = *(const u32x4*)(G + o);
        u32x4 vp = (u32x4){0u, 0u, 0u, 0u}, vn = (u32x4){0u, 0u, 0u, 0u};
        if (pos > 0) vp = *(const u32x4*)(V + o - DM);
        if (pos < len - 1) vn = *(const u32x4*)(V + o + DM);
        const f32x4 w0a = *(const f32x4*)(cw + c), w0b = *(const f32x4*)(cw + c + 4), w1a = *(const f32x4*)(cw + DM + c), w1b = *(const f32x4*)(cw + DM + c + 4), w2a = *(const f32x4*)(cw + 2 * DM + c), w2b = *(const f32x4*)(cw + 2 * DM + c + 4);
        float w0[8], w1[8], w2[8];
#pragma unroll
        for (int e = 0; e < 4; ++e) { w0[e] = w0a[e]; w0[e + 4] = w0b[e]; w1[e] = w1a[e]; w1[e + 4] = w1b[e]; w2[e] = w2a[e]; w2[e + 4] = w2b[e]; }
        f32x4 ya, yb;
#pragma unroll
        for (int k = 0; k < 4; ++k) {
            const float lo = bf_lo(gb[k]) * (w0[2 * k] * bf_lo(vp[k]) + w1[2 * k] * bf_lo(vc[k]) + w2[2 * k] * bf_lo(vn[k]));
            const float hi = bf_hi(gb[k]) * (w0[2 * k + 1] * bf_hi(vp[k]) + w1[2 * k + 1] * bf_hi(vc[k]) + w2[2 * k + 1] * bf_hi(vn[k]));
            if (k < 2) { ya[2 * k] = lo; ya[2 * k + 1] = hi; } else { yb[2 * k - 4] = lo; yb[2 * k - 3] = hi; }
        }
        *(u32x4*)(Y + o) = pack8(ya, yb);
    }
}

__device__ __forceinline__ void tr_tile(LAS float* tl, const float* src, int ldsrc, bf16_t* dst, int K, int k0, const int tid) {
#pragma unroll
    for (int i = 0; i < 8; ++i) { const int kr = (tid >> 6) + 8 * i, cc = tid & 63; tl[kr * 65 + cc] = src[(size_t)(k0 + kr) * ldsrc + cc]; }
    __syncthreads();
    { const int jr = tid >> 3, kg = (tid & 7) * 8; f32x4 a, b;
#pragma unroll
      for (int q = 0; q < 4; ++q) { a[q] = tl[(kg + q) * 65 + jr]; b[q] = tl[(kg + 4 + q) * 65 + jr]; }
      *(u32x4*)(dst + (size_t)jr * K + k0 + kg) = pack8(a, b); }
    __syncthreads();
}

__device__ __forceinline__ void prep_phase(const Args& a, LAS unsigned char* lds, const int tid, const int cid) {
    unsigned char* ws = a.ws;
    const size_t gtid = (size_t)cid * 512 + tid, gsz = (size_t)gridDim.x * 512;
    const float* xp = a.in[0]; const float* xs = a.in[1];
    { bf16_t* xb = (bf16_t*)(ws + WS_R + R_XB);
      for (size_t it = gtid; it < (size_t)T * 128; it += gsz) { const size_t t = it >> 7; const int c = (int)(it & 127) * 8;
          const float* s = t < (size_t)TP ? xp + t * DM + c : xs + (t - TP) * DM + c;
          *(u32x4*)(xb + t * DM + c) = pack8(*(const f32x4*)s, *(const f32x4*)(s + 4)); } }
    { f32x2* st = (f32x2*)(ws + WS_STATS); for (size_t i = gtid; i < (size_t)T; i += gsz) st[i] = (f32x2){0.f, 1.f};
      if (gtid < 1024) { ((float*)(ws + WS_ONES))[gtid] = 1.0f; ((float*)(ws + WS_ZEROS))[gtid] = 0.0f; } }
    { float* pc = (float*)(ws + WS_TWPC); float* ps = (float*)(ws + WS_TWPS); float* sc = (float*)(ws + WS_TWSC); float* ss = (float*)(ws + WS_TWSS);
      for (size_t i = gtid; i < 16384; i += gsz) { const int k1 = (int)(i >> 7), n2 = (int)(i & 127); float s_, c_; sincospif((float)(k1 * n2) * (1.0f / 8192.0f), &s_, &c_); pc[i] = c_; ps[i] = s_; }
      for (size_t i = gtid; i < 8192; i += gsz) { const int k1 = (int)(i >> 6), n2 = (int)(i & 63); float s_, c_; sincospif((float)(k1 * n2) * (1.0f / 4096.0f), &s_, &c_); sc[i] = c_; ss[i] = s_; } }
    { bf16_t* F1 = (bf16_t*)(ws + WS_F1); bf16_t* F3p = (bf16_t*)(ws + WS_F3P); bf16_t* F3s = (bf16_t*)(ws + WS_F3S);
      const float is128 = 0.08838834764831845f, is64 = 0.125f;
      for (size_t i = gtid; i < 65536; i += gsz) {
          const int r = (int)(i >> 8), k = (int)(i & 255);
          { const int ro = r >> 7, k1 = r & 127, ri = k >> 7, n1 = k & 127; float s_, c_; sincospif((float)((k1 * n1) & 127) * (1.0f / 64.0f), &s_, &c_);
            const float v = (ro == ri) ? c_ : (ro == 0 ? s_ : -s_); F1[i] = (bf16_t)(cvt_pk_bf16(v * is128, 0.f) & 0xffffu); }
          { float v = 0.f; if (r < 128) { const int ri = k >> 7, n2 = k & 127; float s_, c_; sincospif((float)((r * n2) & 127) * (1.0f / 64.0f), &s_, &c_); v = (ri == 0 ? c_ : s_) * is128; }
            F3p[i] = (bf16_t)(cvt_pk_bf16(v, 0.f) & 0xffffu); }
          { float v = 0.f; if (r < 128) { const int clo_r = r >> 6, k2 = r & 63, clo_k = k >> 7, ri = (k >> 6) & 1, n2 = k & 63;
                if (clo_r == clo_k) { float s_, c_; sincospif((float)((k2 * n2) & 63) * (1.0f / 32.0f), &s_, &c_); v = (ri == 0 ? c_ : s_) * is64; } }
            F3s[i] = (bf16_t)(cvt_pk_bf16(v, 0.f) & 0xffffu); }
      } }
    { LAS float* tab = (LAS float*)lds;
      if (tid < 128) tab[tid] = cospif((float)tid * (1.0f / 64.0f));
      __syncthreads();
      const float* win = a.in[7]; bf16_t* Wy = (bf16_t*)(ws + WS_WY);
      for (size_t o = gtid; o < (size_t)2048 * 1024; o += gsz) {
          const int c = (int)(o & 1023), ri = (int)(o >> 10) & 1, d = (int)(o >> 11), g = c >> 7, kc = c & 127;
          const float* wr_ = win + (size_t)d * 1024 + g * 128; float s = 0.f;
          const int ph0 = ri ? 32 : 0;
          for (int cp = 0; cp < 128; ++cp) s += wr_[cp] * tab[(cp * kc + ph0) & 127];
          Wy[(size_t)(ri * 1024 + c) * 1024 + d] = (bf16_t)(cvt_pk_bf16(s * 0.08838834764831845f, 0.f) & 0xffffu);
      }
      __syncthreads(); }
    { LAS float* tl = (LAS float*)lds;
      const int NT_GU = 4 * 88 * 16, NT_WD = 4 * 16 * 44, NT_FO = 256, NT_CI = 48 * 16, NT_CO = 256, NT_ALL = NT_GU + NT_WD + NT_FO + NT_CI + NT_CO;
      for (int tix = cid; tix < NT_ALL; tix += gridDim.x) {
          int x = tix;
          if (x < NT_GU) { const int lf = x / (88 * 16), r = x % (88 * 16), jt = r / 16, kt = r % 16, j0 = jt * 64, pn = j0 >> 8, jj = j0 & 255;
              const float* src = (jj < 128 ? a.in[2] : a.in[3]) + (size_t)lf * DM * DFF + pn * 128 + (jj & 127);
              tr_tile(tl, src, DFF, (bf16_t*)(ws + WS_WGU) + (size_t)lf * 5632 * 1024 + (size_t)j0 * 1024, 1024, kt * 64, tid); continue; }
          x -= NT_GU;
          if (x < NT_WD) { const int lf = x / (16 * 44), r = x % (16 * 44), jt = r / 44, kt = r % 44, j0 = jt * 64;
              tr_tile(tl, a.in[4] + (size_t)lf * DFF * DM + j0, DM, (bf16_t*)(ws + WS_WD) + (size_t)lf * 1024 * 2816 + (size_t)j0 * 2816, 2816, kt * 64, tid); continue; }
          x -= NT_WD;
          if (x < NT_FO) { const int jt = x / 16, kt = x % 16, j0 = jt * 64; tr_tile(tl, a.in[8] + j0, DM, (bf16_t*)(ws + WS_WFO) + (size_t)j0 * 1024, 1024, kt * 64, tid); continue; }
          x -= NT_FO;
          if (x < NT_CI) { const int jt = x / 16, kt = x % 16, j0 = jt * 64, pn = j0 >> 8, jj = j0 & 255;
              const int col = pn < 8 ? (jj < 128 ? 1024 + pn * 128 + jj : 2048 + pn * 128 + (jj - 128)) : (pn - 8) * 256 + jj;
              tr_tile(tl, a.in[9] + col, 3072, (bf16_t*)(ws + WS_WCI) + (size_t)j0 * 1024, 1024, kt * 64, tid); continue; }
          x -= NT_CI;
          { const int jt = x / 16, kt = x % 16, j0 = jt * 64; tr_tile(tl, a.in[11] + j0, DM, (bf16_t*)(ws + WS_WCO) + (size_t)j0 * 1024, 1024, kt * 64, tid); }
      } }
}

template <bool COOP>
__global__ void __launch_bounds__(512, 2) fwd(Args a) {
    extern __shared__ __attribute__((aligned(16))) unsigned char lds_raw[];
    LAS unsigned char* lds = (LAS unsigned char*)lds_raw;
    unsigned char* ws = a.ws;
    bf16_t* R = (bf16_t*)(ws + WS_R);
    bf16_t* const XB = (bf16_t*)(ws + WS_R + R_XB); bf16_t* const HB = (bf16_t*)(ws + WS_R + R_H);
    bf16_t* const DB = (bf16_t*)(ws + WS_R + R_D); bf16_t* const EB = (bf16_t*)(ws + WS_R + R_E); bf16_t* const FB = (bf16_t*)(ws + WS_R + R_F);
    bf16_t* const VB = (bf16_t*)(ws + WS_R + R_V); bf16_t* const GB = (bf16_t*)(ws + WS_R + R_G); bf16_t* const YB = (bf16_t*)(ws + WS_R + R_Y);
    (void)R;
    f32x2* const stats = (f32x2*)(ws + WS_STATS);
    const float* const ones = (const float*)(ws + WS_ONES); const float* const zeros = (const float*)(ws + WS_ZEROS);
    const float* const lng = a.in[5]; const float* const lnb = a.in[6];
    const int G = (int)gridDim.x;

#pragma unroll 1
    for (int ph = a.ph_lo; ph < a.ph_hi; ++ph) {
        int tid = threadIdx.x, cid = blockIdx.x;
        asm volatile("" : "+v"(tid), "+s"(cid));
        int kind, p0 = 0, p1 = 0;
        switch (ph) {
            case 0: kind = 0; break;
            case 1: kind = 1; p0 = 0; break;
            case 2: kind = 2; p0 = 0; p1 = -1; break;
            case 3: kind = 3; p0 = 0; p1 = 1; break;
            case 4: kind = 4; break;
            case 5: kind = 5; break;
            case 6: kind = 6; break;
            case 7: kind = 2; p0 = 4; p1 = 0; break;
            case 8: kind = 3; p0 = 1; break;
            case 9: kind = 1; p0 = 1; break;
            case 10: kind = 2; p0 = 1; p1 = 1; break;
            case 11: kind = 3; p0 = 2; break;
            case 12: kind = 1; p0 = 2; break;
            case 13: kind = 2; p0 = 2; p1 = 2; break;
            case 14: kind = 3; p0 = 3; break;
            case 15: kind = 7; break;
            case 16: kind = 8; break;
            case 17: kind = 2; p0 = 5; p1 = 3; break;
            case 18: kind = 3; p0 = 4; break;
            case 19: kind = 1; p0 = 3; break;
            case 20: kind = 2; p0 = 3; p1 = 4; break;
            default: kind = 3; p0 = 5; p1 = 2; break;
        }
#ifdef ONLY_KIND
        kind = ONLY_KIND;
#endif
        if (kind == 0) {
            prep_phase(a, lds, tid, cid);
        } else if (kind == 1) {
            pg8::Gemm g{XB, (const bf16_t*)(ws + WS_WGU) + (size_t)p0 * 5632 * 1024, T, 5632, 1024};
            pg8::StaticOrder S; S.init(g.M, g.N, G, cid);
            EpiGU E{HB};
            pg8::gemm_phase<EpiGU>(lds, g, S, E, tid);
        } else if (kind == 2) {
            pg8::Gemm g;
            float scale;
            if (p0 < 4) { g = pg8::Gemm{HB, (const bf16_t*)(ws + WS_WD) + (size_t)p0 * 1024 * 2816, T, 1024, 2816}; scale = 0.5f; }
            else if (p0 == 4) { g = pg8::Gemm{FB, (const bf16_t*)(ws + WS_WFO), T, 1024, 1024}; scale = 1.0f; }
            else { g = pg8::Gemm{YB, (const bf16_t*)(ws + WS_WCO), T, 1024, 1024}; scale = 1.0f; }
            pg8::StaticOrder S; S.init(g.M, g.N, G, cid);
            EpiRes E;
            if (p1 < 0) { E.zin0 = a.in[0]; E.zin1 = a.in[1]; E.gam = ones; E.bet = zeros; }
            else { E.zin0 = a.out; E.zin1 = a.out + (size_t)TP * DM; E.gam = lng + p1 * DM; E.bet = lnb + p1 * DM; }
            E.zout = a.out; E.stats = stats; E.scale = scale;
            pg8::gemm_phase<EpiRes>(lds, g, S, E, tid);
        } else if (kind == 3) {
            ln_pass(a.out, stats, lng + p0 * DM, lnb + p0 * DM, XB, p1 == 1, p1 == 2, tid, cid);
        } else if (kind == 4) {
            pg8::Gemm g{(const bf16_t*)(ws + WS_WY), XB, 2048, T, 1024};
            pg8::StaticOrder S; S.init(g.M, g.N, G, cid);
            EpiD E{DB};
            pg8::gemm_phase<EpiD>(lds, g, S, E, tid);
        } else if (kind == 5) {
            pg8::Gemm g{(const bf16_t*)(ws + WS_F1), DB, 256, 786432, 256};
            pg8::StaticOrder S; S.init(g.M, g.N, G, cid);
            EpiB1 E{EB, (const float*)(ws + WS_TWPC), (const float*)(ws + WS_TWPS), (const float*)(ws + WS_TWSC), (const float*)(ws + WS_TWSS)};
            pg8::gemm_phase<EpiB1>(lds, g, S, E, tid);
        } else if (kind == 6) {
#pragma unroll 1
            for (int s = 0; s < 2; ++s) {
                pg8::Gemm g{(const bf16_t*)(ws + (s ? WS_F3S : WS_F3P)), EB + (s ? ES_BASE : 0), 256, s ? 524288 : 262144, 256};
                pg8::StaticOrder S; S.init(g.M, g.N, G, cid);
                EpiB3 E{FB, s};
                pg8::gemm_phase<EpiB3>(lds, g, S, E, tid);
            }
        } else if (kind == 7) {
            pg8::Gemm g{XB, (const bf16_t*)(ws + WS_WCI), T, 3072, 1024};
            pg8::StaticOrder S; S.init(g.M, g.N, G, cid);
            EpiCI E{VB, GB};
            pg8::gemm_phase<EpiCI>(lds, g, S, E, tid);
        } else {
            conv_pass(VB, GB, a.in[10], YB, tid, cid);
        }
        if (ph + 1 < a.ph_hi) { if constexpr (COOP) cg::this_grid().sync(); }
    }
}

extern "C" void kernel_launch(void* const* d_in, const int* in_sizes, int n_in, void* d_out, int out_size, void* d_ws, size_t ws_size, hipStream_t stream) {
    static int grid = 0;
    constexpr int LDS_BYTES = pg8::STAGE_BYTES;
    if (grid == 0) {
        if (n_in != 12 || out_size != T * DM || ws_size < WS_END) { fprintf(stderr, "kernel_launch: unexpected shapes (n_in %d out %d ws %zu, need %zu)\n", n_in, out_size, ws_size, (size_t)WS_END); grid = -1; return; }
        int dev = 0, cus = 0, per_cu = 0;
        hipGetDevice(&dev); hipDeviceGetAttribute(&cus, hipDeviceAttributeMultiprocessorCount, dev);
        hipFuncSetAttribute((const void*)fwd<true>, hipFuncAttributeMaxDynamicSharedMemorySize, LDS_BYTES);
        hipFuncSetAttribute((const void*)fwd<false>, hipFuncAttributeMaxDynamicSharedMemorySize, LDS_BYTES);
        hipOccupancyMaxActiveBlocksPerMultiprocessor(&per_cu, (const void*)fwd<true>, 512, LDS_BYTES);
        (void)hipGetLastError();
        if (per_cu < 1) per_cu = 1;
        grid = cus;
        fprintf(stderr, "kernel_launch: cus %d per_cu %d grid %d\n", cus, per_cu, grid);
    }
    if (grid < 0) return;
    Args a{};
    for (int i = 0; i < 12; ++i) a.in[i] = (const float*)d_in[i];
    a.out = (float*)d_out; a.ws = (unsigned char*)d_ws;
#if MK_COOP
    a.ph_lo = 0; a.ph_hi = NPH;
    void* args[] = {&a};
    hipError_t e = hipLaunchCooperativeKernel((const void*)fwd<true>, dim3(grid), dim3(512), args, LDS_BYTES, stream);
    if (e != hipSuccess) fprintf(stderr, "cooperative launch failed: %s\n", hipGetErrorString(e));
#else
    for (int ph = 0; ph < NPH; ++ph) { a.ph_lo = ph; a.ph_hi = ph + 1; hipLaunchKernelGGL(fwd<false>, dim3(grid), dim3(512), LDS_BYTES, stream, a); }
#endif
}
```

```cpp
#include <hip/hip_runtime.h>
#include <hip/hip_cooperative_groups.h>
#include <cstdio>
namespace cg = cooperative_groups;

#ifndef MK_COOP
#define MK_COOP 1
#endif

#define LAS __attribute__((address_space(3)))
typedef unsigned short bf16_t;
typedef short bf16x8 __attribute__((ext_vector_type(8)));
typedef float f32x4 __attribute__((ext_vector_type(4)));
typedef float f32x2 __attribute__((ext_vector_type(2)));
typedef unsigned u32x4 __attribute__((ext_vector_type(4)));
typedef unsigned u32x2 __attribute__((ext_vector_type(2)));

constexpr int DM = 1024, DFF = 2816, TP = 32768  , TS = 65536  , T = TP + TS;
constexpr float ALPHA = 1.41421356237f;
constexpr float LN_EPS = 1e-5f;
constexpr int NPH = 22;

constexpr size_t MiB = 1024 * 1024;
constexpr size_t WS_ONES = 0, WS_ZEROS = 4096, WS_STATS = 8192;
constexpr size_t WS_TWPC = WS_STATS + (size_t)T * 8, WS_TWPS = WS_TWPC + 65536, WS_TWSC = WS_TWPS + 65536, WS_TWSS = WS_TWSC + 32768;
constexpr size_t WS_F1 = WS_TWSS + 32768, WS_F3P = WS_F1 + 131072, WS_F3S = WS_F3P + 131072;
constexpr size_t WS_WGU = 2 * MiB;
constexpr size_t WS_WD = WS_WGU + 4ull * 5632 * 1024 * 2;
constexpr size_t WS_WY = WS_WD + 4ull * 1024 * 2816 * 2;
constexpr size_t WS_WFO = WS_WY + 2048ull * 1024 * 2, WS_WCI = WS_WFO + 1024ull * 1024 * 2, WS_WCO = WS_WCI + 3072ull * 1024 * 2;
constexpr size_t WS_R = 84 * MiB;
constexpr size_t WS_END = WS_R + 768 * MiB;
static_assert(WS_WCO + 1024ull * 1024 * 2 <= WS_R, "weights overflow");
static_assert(WS_F3S + 131072 <= WS_WGU, "tables overflow");
constexpr size_t R_H = 0, R_XB = 576 * MiB, R_D = 0, R_E = 384 * MiB, R_F = 0, R_V = 0, R_G = 192 * MiB, R_Y = 384 * MiB;
constexpr size_t ES_BASE = 67108864;

__device__ __forceinline__ unsigned cvt_pk_bf16(float lo, float hi) { unsigned r; asm volatile("v_cvt_pk_bf16_f32 %0, %1, %2" : "=v"(r) : "v"(lo), "v"(hi)); return r; }
__device__ __forceinline__ u32x4 pack8(const f32x4 a, const f32x4 b) { u32x4 w; w.x = cvt_pk_bf16(a[0], a[1]); w.y = cvt_pk_bf16(a[2], a[3]); w.z = cvt_pk_bf16(b[0], b[1]); w.w = cvt_pk_bf16(b[2], b[3]); return w; }
__device__ __forceinline__ float bf_lo(unsigned w) { return __uint_as_float(w << 16); }
__device__ __forceinline__ float bf_hi(unsigned w) { return __uint_as_float(w & 0xffff0000u); }

namespace pg8 {
constexpr int BM = 256, BK = 64, HALF = 128, HTB = HALF * BK * 2, STAGE_BYTES = 8 * HTB, NXCD = 8, WGM = 8;
__device__ __forceinline__ int lds_byte(int r, int c) { const int st = (r >> 4) * 2 + (c >> 5), rr = r & 15, cc = c & 31, ob = rr * 64 + cc * 2; return st * 1024 + (ob ^ (((ob >> 9) & 1) << 5)); }
__device__ __forceinline__ void stage_rc(int b, int& R, int& C) { const int st = b / 1024, sb = b % 1024, swz = sb ^ (((sb >> 9) & 1) << 5); R = (st >> 1) * 16 + swz / 64; C = (st & 1) * 32 + (swz % 64) / 2; }
__device__ __forceinline__ int perm32(int rho) { const int n = rho >> 4, i = rho & 15; return 8 * (i >> 2) + 4 * n + (i & 3); }
struct Unit { int pm, pn; };
struct Gemm { const bf16_t* A; const bf16_t* Bt; int M, N, K; };
struct StaticOrder {
    int nM, nN, nwg, G, c;
    __device__ void init(int M, int N, int G_, int c_) { nM = M / BM; nN = N / BM; nwg = nM * nN; G = G_; c = c_; }
    __device__ bool next(int i, Unit& u) const {
        const long L = (long)i * G + c; if (L >= nwg) return false;
        int wgid = (int)L; { const int q = nwg / NXCD, r = nwg % NXCD, xcd = wgid % NXCD, off = wgid / NXCD; wgid = (xcd < r ? xcd * (q + 1) : r * (q + 1) + (xcd - r) * q) + off; }
        const int nig = WGM * nN, gid = wgid / nig, fm = gid * WGM, gsz = (nM - fm) < WGM ? (nM - fm) : WGM;
        u.pm = fm + ((wgid % nig) % gsz); u.pn = (wgid % nig) / gsz; return true;
    }
};

template <class Epi>
__device__ __forceinline__ void gemm_phase(LAS unsigned char* lds, const Gemm g, const StaticOrder& S, const Epi& E, const int tid) {
    const int wid = __builtin_amdgcn_readfirstlane(tid >> 6), lane = tid & 63, wr = wid >> 2, wc = wid & 3, fr = lane & 15, fq = lane >> 4;
    const int K = g.K, nt = K / BK;
    unsigned voffA[2], voffB[2];
#pragma unroll
    for (int i = 0; i < 2; ++i) { int R, C; stage_rc(tid * 16 + i * 8192, R, C); const int Rb = Epi::PERM ? ((R & ~31) + perm32(R & 31)) : R;
        voffA[i] = (unsigned)(R * K + C) * 2u; voffB[i] = (unsigned)(Rb * K + C) * 2u; }
    const size_t kstep = (size_t)(BK * 2);
    const size_t hstep = (size_t)HALF * K * 2;
    const size_t tstep = 2 * hstep;
    const unsigned ldsw = (unsigned)wid * 1024u;
    const int aoff = lds_byte(wr * 64 + fr, fq * 8), boff = lds_byte(wc * 32 + fr, fq * 8);
#define PG8_SA(b, h) (((b) * 2 + (h)) * HTB)
#define PG8_SB(b, h) ((4 + (b) * 2 + (h)) * HTB)
#define PG8_STAGE(bufoff, gbase, voff) do { _Pragma("unroll") for (int _i = 0; _i < 2; ++_i) \
        __builtin_amdgcn_global_load_lds((const unsigned*)((const char*)(gbase) + (voff)[_i]), (LAS unsigned*)(lds + (bufoff) + ldsw + _i * 8192), 16, 0, 0); } while (0)
#define PG8_LDA(dst, b, h) do { _Pragma("unroll") for (int m = 0; m < 4; ++m) _Pragma("unroll") for (int k = 0; k < 2; ++k) dst[m][k] = *(const LAS bf16x8*)(lds + PG8_SA(b, h) + aoff + m * 2048 + k * 1024); } while (0)
#define PG8_LDB(dst, b, h) do { _Pragma("unroll") for (int n = 0; n < 2; ++n) _Pragma("unroll") for (int k = 0; k < 2; ++k) dst[n][k] = *(const LAS bf16x8*)(lds + PG8_SB(b, h) + boff + n * 2048 + k * 1024); } while (0)
#define PG8_MMA(ai, bj, At, Bt) do { __builtin_amdgcn_s_setprio(1); _Pragma("unroll") for (int m = 0; m < 4; ++m) _Pragma("unroll") for (int n = 0; n < 2; ++n) _Pragma("unroll") for (int k = 0; k < 2; ++k) \
        acc[ai][bj][m][n] = __builtin_amdgcn_mfma_f32_16x16x32_bf16(Bt[n][k], At[m][k], acc[ai][bj][m][n], 0, 0, 0); __builtin_amdgcn_s_setprio(0); } while (0)
#define PG8_WAIT_V(n) asm volatile("s_waitcnt vmcnt(" #n ")" ::: "memory")
#define PG8_WAIT_L(n) asm volatile("s_waitcnt lgkmcnt(" #n ")" ::: "memory")
#define PG8_BAR __builtin_amdgcn_s_barrier()
#define PG8_SCHED __builtin_amdgcn_sched_barrier(0)
    Unit cur, nxt; int ui = 0;
    if (!S.next(0, cur)) return;
    f32x4 acc[2][2][4][2];
#pragma unroll
    for (int a = 0; a < 2; ++a)
#pragma unroll
        for (int b = 0; b < 2; ++b)
#pragma unroll
            for (int m = 0; m < 4; ++m)
#pragma unroll
                for (int n = 0; n < 2; ++n) acc[a][b][m][n] = (f32x4){0.f, 0.f, 0.f, 0.f};
    bf16x8 At[4][2], B0[2][2], B1[2][2];
    const char* cA = (const char*)g.A + (size_t)cur.pm * tstep; const char* cB = (const char*)g.Bt + (size_t)cur.pn * tstep;
    PG8_STAGE(PG8_SB(0, 0), cB, voffB); PG8_STAGE(PG8_SA(0, 0), cA, voffA); PG8_STAGE(PG8_SB(0, 1), cB + hstep, voffB); PG8_STAGE(PG8_SA(0, 1), cA + hstep, voffA);
    if (wr == 1) PG8_BAR;
    PG8_WAIT_V(4); PG8_BAR;
    PG8_STAGE(PG8_SB(1, 0), cB + kstep, voffB); PG8_STAGE(PG8_SA(1, 0), cA + kstep, voffA); PG8_STAGE(PG8_SB(1, 1), cB + hstep + kstep, voffB);
    PG8_WAIT_V(6); PG8_BAR;
    for (;;) {
        const bool has_next = S.next(ui + 1, nxt);
        const char* nA = has_next ? (const char*)g.A + (size_t)nxt.pm * tstep : cA; const char* nB = has_next ? (const char*)g.Bt + (size_t)nxt.pn * tstep : cB;
#pragma unroll 1
        for (int t = 0; t < nt; t += 2) {
            const bool last = (t == nt - 2);
            const char* a1 = cA + (size_t)(t + 1) * kstep;
            const char* a2 = last ? nA : cA + (size_t)(t + 2) * kstep; const char* b2 = last ? nB : cB + (size_t)(t + 2) * kstep;
            const char* a3 = a2 + kstep; const char* b3 = b2 + kstep;
            PG8_LDB(B0, 0, 0); PG8_SCHED; PG8_LDA(At, 0, 0); PG8_STAGE(PG8_SA(1, 1), a1 + hstep, voffA);
            PG8_WAIT_L(8); PG8_BAR; PG8_WAIT_L(0); PG8_MMA(0, 0, At, B0); PG8_BAR; PG8_SCHED;
            PG8_LDB(B1, 0, 1); PG8_STAGE(PG8_SB(0, 0), b2, voffB);
            PG8_BAR; PG8_WAIT_L(0); PG8_MMA(0, 1, At, B1); PG8_BAR;
            PG8_LDA(At, 0, 1); PG8_STAGE(PG8_SA(0, 0), a2, voffA);
            PG8_BAR; PG8_WAIT_L(0); PG8_MMA(1, 0, At, B0); PG8_BAR; PG8_SCHED;
            PG8_STAGE(PG8_SB(0, 1), b2 + hstep, voffB);
            PG8_WAIT_V(6); PG8_BAR; PG8_MMA(1, 1, At, B1); PG8_BAR;
            PG8_LDB(B0, 1, 0); PG8_SCHED; PG8_LDA(At, 1, 0); PG8_STAGE(PG8_SA(0, 1), a2 + hstep, voffA);
            PG8_WAIT_L(8); PG8_BAR; PG8_WAIT_L(0); PG8_MMA(0, 0, At, B0); PG8_BAR; PG8_SCHED;
            PG8_LDB(B1, 1, 1); PG8_STAGE(PG8_SB(1, 0), b3, voffB);
            PG8_BAR; PG8_WAIT_L(0); PG8_MMA(0, 1, At, B1); PG8_BAR;
            PG8_LDA(At, 1, 1); PG8_STAGE(PG8_SA(1, 0), a3, voffA);
            PG8_BAR; PG8_WAIT_L(0); PG8_MMA(1, 0, At, B0); PG8_BAR; PG8_SCHED;
            PG8_STAGE(PG8_SB(1, 1), b3 + hstep, voffB);
            PG8_WAIT_V(6); PG8_BAR; PG8_MMA(1, 1, At, B1); PG8_BAR;
        }
        { int fr_ = fr, fq_ = fq, wr_ = wr, wc_ = wc; asm volatile("" : "+v"(fr_), "+v"(fq_), "+s"(wr_), "+s"(wc_));
          E(acc, cur, wr_, wc_, fr_, fq_, lds + STAGE_BYTES + wid * 2048); }
        if (!has_next) break;
#pragma unroll
        for (int a = 0; a < 2; ++a)
#pragma unroll
            for (int b = 0; b < 2; ++b)
#pragma unroll
                for (int m = 0; m < 4; ++m)
#pragma unroll
                    for (int n = 0; n < 2; ++n) acc[a][b][m][n] = (f32x4){0.f, 0.f, 0.f, 0.f};
        cur = nxt; cA = nA; cB = nB; ++ui;
    }
    PG8_WAIT_V(0);
    if (wr == 0) PG8_BAR;
    PG8_BAR;
#undef PG8_SA
#undef PG8_SB
#undef PG8_STAGE
#undef PG8_LDA
#undef PG8_LDB
#undef PG8_MMA
#undef PG8_WAIT_V
#undef PG8_WAIT_L
#undef PG8_BAR
#undef PG8_SCHED
}
}
using pg8::Unit;

__device__ __forceinline__ float silu_f(float g) { return g * __builtin_amdgcn_rcpf(1.0f + __expf(-g)); }

struct EpiGU {
    static constexpr bool PREF = false;
    static constexpr bool PERM = true;
    bf16_t* H;
    __device__ __forceinline__ void operator()(const f32x4 (&acc)[2][2][4][2], const Unit& u, int wr, int wc, int fr, int fq, LAS unsigned char* wlds) const {
        const int row0 = u.pm * 256 + wr * 64 + fr, col0 = u.pn * 128 + wc * 32 + 8 * fq;
#pragma unroll
        for (int ai = 0; ai < 2; ++ai)
#pragma unroll
            for (int m = 0; m < 4; ++m) {
                f32x4 h0, h1;
#pragma unroll
                for (int j = 0; j < 4; ++j) { h0[j] = silu_f(acc[ai][0][m][0][j]) * acc[ai][1][m][0][j]; h1[j] = silu_f(acc[ai][0][m][1][j]) * acc[ai][1][m][1][j]; }
                *(u32x4*)(H + (size_t)(row0 + ai * 128 + m * 16) * DFF + col0) = pack8(h0, h1);
            }
    }
};

struct EpiRes {
    static constexpr bool PREF = false;
    static constexpr bool PERM = false;
    const float* zin0; const float* zin1; float* zout; const f32x2* stats; const float* gam; const float* bet; float scale;
    __device__ __forceinline__ void operator()(const f32x4 (&acc)[2][2][4][2], const Unit& u, int wr, int wc, int fr, int fq, LAS unsigned char* wlds) const {
        const int l = fr + 16 * fq, lr = l >> 3, lc = l & 7;
        const int wo = fr * 128 + ((fq ^ (fr & 7)) << 4);
        (void)wo;
        const int ro = lr * 128 + ((lc ^ lr) << 4);
        const int rowb = u.pm * 256 + wr * 64 + lr, colb = u.pn * 256 + wc * 32 + lc * 4;
        const float* zi = (u.pm < 128) ? zin0 + (size_t)rowb * DM + colb : zin1 + (size_t)(rowb - TP) * DM + colb;
        float* zo = zout + (size_t)rowb * DM + colb;
        const f32x2* sp = stats + rowb;
#pragma unroll
        for (int bj = 0; bj < 2; ++bj) {
            const f32x4 g = *(const f32x4*)(gam + colb + bj * 128) * ALPHA, b = *(const f32x4*)(bet + colb + bj * 128) * ALPHA;
#pragma unroll
            for (int ai = 0; ai < 2; ++ai) {
                f32x4 zv[4][2]; f32x2 sv[4][2];
#pragma unroll
                for (int m = 0; m < 4; ++m)
#pragma unroll
                    for (int h = 0; h < 2; ++h) { const int ro_ = ai * 128 + m * 16 + h * 8; zv[m][h] = *(const f32x4*)(zi + (size_t)ro_ * DM + bj * 128); sv[m][h] = sp[ro_]; }
#pragma unroll
                for (int m = 0; m < 4; ++m) {
#pragma unroll
                    for (int n = 0; n < 2; ++n) *(LAS f32x4*)(wlds + fr * 128 + (((n * 4 + fq) ^ (fr & 7)) << 4)) = acc[ai][bj][m][n];
                    const f32x4 v0 = *(const LAS f32x4*)(wlds + ro), v1 = *(const LAS f32x4*)(wlds + ro + 8 * 128);
                    const int ro_ = ai * 128 + m * 16;
                    *(f32x4*)(zo + (size_t)ro_ * DM + bj * 128) = (zv[m][0] - sv[m][0].x) * sv[m][0].y * g + b + v0 * scale;
                    *(f32x4*)(zo + (size_t)(ro_ + 8) * DM + bj * 128) = (zv[m][1] - sv[m][1].x) * sv[m][1].y * g + b + v1 * scale;
                }
            }
        }
    }
};

struct EpiD {
    static constexpr bool PREF = false;
    static constexpr bool PERM = true;
    bf16_t* D;
    __device__ __forceinline__ void operator()(const f32x4 (&acc)[2][2][4][2], const Unit& u, int wr, int wc, int fr, int fq, LAS unsigned char* wlds) const {
        const int n1 = wc * 32 + 8 * fq;
#pragma unroll
        for (int bj = 0; bj < 2; ++bj) {
            const int chunk = 2 * u.pn + bj; int rb, cs;
            if (chunk < 256) { const int b = chunk >> 7, n2 = chunk & 127; rb = b * 1024 * 128 + n2; cs = 128; }
            else { const int ch = chunk - 256, b = ch >> 6, n2 = ch & 63; rb = 262144 + b * 1024 * 64 + n2; cs = 64; }
#pragma unroll
            for (int ai = 0; ai < 2; ++ai)
#pragma unroll
                for (int m = 0; m < 4; ++m) {
                    const int i = u.pm * 256 + ai * 128 + wr * 64 + m * 16 + fr, ri = i >> 10, c = i & 1023;
                    *(u32x4*)(D + (size_t)(rb + c * cs) * 256 + ri * 128 + n1) = pack8(acc[ai][bj][m][0], acc[ai][bj][m][1]);
                }
        }
    }
};

struct EpiB1 {
    static constexpr bool PREF = false;
    static constexpr bool PERM = true;
    bf16_t* E; const float* twpc; const float* twps; const float* twsc; const float* twss;
    __device__ __forceinline__ void operator()(const f32x4 (&acc)[2][2][4][2], const Unit& u, int wr, int wc, int fr, int fq, LAS unsigned char* wlds) const {
        const bool pr = u.pn < 1024;
#pragma unroll
        for (int bj = 0; bj < 2; ++bj) {
            const int j0 = u.pn * 256 + bj * 128 + wc * 32 + 8 * fq;
            int bc, n2;
            if (pr) { bc = j0 >> 7; n2 = j0 & 127; } else { const int jj = j0 - 262144; bc = jj >> 6; n2 = jj & 63; }
            const int b = bc >> 10, c = bc & 1023;
#pragma unroll
            for (int m = 0; m < 4; ++m) {
                const int k1 = wr * 64 + m * 16 + fr;
                const float* tc = pr ? twpc : twsc; const float* ts = pr ? twps : twss;
                const unsigned two = pr ? (unsigned)(k1 * 128 + n2) : (unsigned)(k1 * 64 + n2);
                unsigned eoff; int istr;
                if (pr) { eoff = (unsigned)((b * 128 + k1) * 1024 + c) * 256u + n2; istr = 128; }
                else { eoff = (unsigned)ES_BASE + (unsigned)((b * 128 + k1) * 512 + (c & 511)) * 256u + (c >> 9) * 128 + n2; istr = 64; }
                u32x4 wr_, wi_;
                { const f32x4 c0 = *(const f32x4*)(tc + two), s0 = *(const f32x4*)(ts + two);
                  const f32x4 tr0 = acc[0][bj][m][0], ti0 = acc[1][bj][m][0];
                  const f32x4 er0 = tr0 * c0 + ti0 * s0, ei0 = ti0 * c0 - tr0 * s0;
                  wr_.x = cvt_pk_bf16(er0[0], er0[1]); wr_.y = cvt_pk_bf16(er0[2], er0[3]); wi_.x = cvt_pk_bf16(ei0[0], ei0[1]); wi_.y = cvt_pk_bf16(ei0[2], ei0[3]); }
                asm volatile("" ::: "memory");
                { const f32x4 c1 = *(const f32x4*)(tc + two + 4), s1 = *(const f32x4*)(ts + two + 4);
                  const f32x4 tr1 = acc[0][bj][m][1], ti1 = acc[1][bj][m][1];
                  const f32x4 er1 = tr1 * c1 + ti1 * s1, ei1 = ti1 * c1 - tr1 * s1;
                  wr_.z = cvt_pk_bf16(er1[0], er1[1]); wr_.w = cvt_pk_bf16(er1[2], er1[3]); wi_.z = cvt_pk_bf16(ei1[0], ei1[1]); wi_.w = cvt_pk_bf16(ei1[2], ei1[3]); }
                *(u32x4*)(E + eoff) = wr_;
                *(u32x4*)(E + eoff + istr) = wi_;
                asm volatile("" ::: "memory");
            }
        }
    }
};

struct EpiB3 {
    static constexpr bool PREF = false;
    static constexpr bool PERM = true;
    bf16_t* F; int sample;
    __device__ __forceinline__ void operator()(const f32x4 (&acc)[2][2][4][2], const Unit& u, int wr, int wc, int fr, int fq, LAS unsigned char* wlds) const {
#pragma unroll
        for (int bj = 0; bj < 2; ++bj) {
            const int j0 = u.pn * 256 + bj * 128 + wc * 32 + 8 * fq;
#pragma unroll
            for (int m = 0; m < 4; ++m) {
                int tok, col;
                if (!sample) { const int c = j0 & 1023, k1 = (j0 >> 10) & 127, b = j0 >> 17, k2 = wr * 64 + m * 16 + fr; tok = b * 16384 + k1 + 128 * k2; col = c; }
                else { const int ch = j0 & 511, k1 = (j0 >> 9) & 127, b = j0 >> 16, k2 = m * 16 + fr; tok = TP + b * 8192 + k1 + 128 * k2; col = wr * 512 + ch; }
                *(u32x4*)(F + (size_t)tok * DM + col) = pack8(acc[0][bj][m][0], acc[0][bj][m][1]);
            }
        }
    }
};

struct EpiCI {
    static constexpr bool PREF = false;
    static constexpr bool PERM = true;
    bf16_t* V; bf16_t* G;
    __device__ __forceinline__ void operator()(const f32x4 (&acc)[2][2][4][2], const Unit& u, int wr, int wc, int fr, int fq, LAS unsigned char* wlds) const {
        const int row0 = u.pm * 256 + wr * 64 + fr;
        if (u.pn < 8) {
            const int col = u.pn * 128 + wc * 32 + 8 * fq;
#pragma unroll
            for (int ai = 0; ai < 2; ++ai)
#pragma unroll
                for (int m = 0; m < 4; ++m)
                    *(u32x4*)(V + (size_t)(row0 + ai * 128 + m * 16) * DM + col) = pack8(acc[ai][0][m][0] * acc[ai][1][m][0], acc[ai][0][m][1] * acc[ai][1][m][1]);
        } else {
#pragma unroll
            for (int ai = 0; ai < 2; ++ai)
#pragma unroll
                for (int m = 0; m < 4; ++m)
#pragma unroll
                    for (int bj = 0; bj < 2; ++bj) {
                        const int col = (u.pn - 8) * 256 + bj * 128 + wc * 32 + 8 * fq;
                        *(u32x4*)(G + (size_t)(row0 + ai * 128 + m * 16) * DM + col) = pack8(acc[ai][bj][m][0], acc[ai][bj][m][1]);
                    }
        }
    }
};

struct Args { const float* in[12]; float* out; unsigned char* ws; int ph_lo, ph_hi; };

__device__ __forceinline__ float wave_sum(float v) {
#pragma unroll
    for (int o = 32; o >= 1; o >>= 1) v += __shfl_xor(v, o);
    return v;
}

__device__ __forceinline__ void ln_pass(float* z, f32x2* stats, const float* gam, const float* bet, bf16_t* xb, int permute, int fin, const int tid, const int cid) {
    const int lane = tid & 63, wave = tid >> 6;
    f32x4 g[4], b[4];
#pragma unroll
    for (int i = 0; i < 4; ++i) { g[i] = ((const f32x4*)gam)[lane + 64 * i]; b[i] = ((const f32x4*)bet)[lane + 64 * i]; }
    for (int row = cid * 8 + wave; row < T; row += gridDim.x * 8) {
        f32x4* zr = (f32x4*)(z + (size_t)row * DM);
        f32x4 v[4];
#pragma unroll
        for (int i = 0; i < 4; ++i) v[i] = zr[lane + 64 * i];
        float s = 0.f;
#pragma unroll
        for (int i = 0; i < 4; ++i) s += (v[i][0] + v[i][1]) + (v[i][2] + v[i][3]);
        const float mean = wave_sum(s) * (1.0f / DM);
        float q = 0.f;
#pragma unroll
        for (int i = 0; i < 4; ++i) { const f32x4 d = v[i] - mean; q += (d[0] * d[0] + d[1] * d[1]) + (d[2] * d[2] + d[3] * d[3]); }
        const float rstd = 1.0f / sqrtf(wave_sum(q) * (1.0f / DM) + LN_EPS);
        if (fin) {
#pragma unroll
            for (int i = 0; i < 4; ++i) zr[lane + 64 * i] = (v[i] - mean) * rstd * g[i] + b[i];
        } else {
            if (lane == 0) stats[row] = (f32x2){mean, rstd};
            int j = row;
            if (permute) {
                if (row < TP) { const int bb = row >> 14, s_ = row & 16383, n1 = s_ >> 7, n2 = s_ & 127; j = (bb * 128 + n2) * 128 + n1; }
                else { const int t_ = row - TP, bb = t_ >> 13, s_ = t_ & 8191, n1 = s_ >> 6, n2 = s_ & 63; j = TP + (bb * 64 + n2) * 128 + n1; }
            }
            u32x2* xr = (u32x2*)(xb + (size_t)j * DM);
#pragma unroll
            for (int i = 0; i < 4; ++i) { const f32x4 y = (v[i] - mean) * rstd * g[i] + b[i]; u32x2 w; w.x = cvt_pk_bf16(y[0], y[1]); w.y = cvt_pk_bf16(y[2], y[3]); xr[lane + 64 * i] = w; }
        }
    }
}

__device__ __forceinline__ void conv_pass(const bf16_t* V, const bf16_t* G, const float* cw, bf16_t* Y, const int tid, const int cid) {
    const size_t gsz = (size_t)gridDim.x * 512;
    for (size_t it = (size_t)cid * 512 + tid; it < (size_t)T * 128; it += gsz) {
        const int t = (int)(it >> 7), c = (int)(it & 127) * 8;
        int pos, len; if (t < TP) { pos = t & 16383; len = 16384; } else { pos = (t - TP) & 8191; len = 8192; }
        const size_t o = (size_t)t * DM + c;
        const u32x4 vc = *(const u32x4*)(V + o), gb = *(const u32x4*)(G + o);
        u32x4 vp = (u32x4){0u, 0u, 0u, 0u}, vn = (u32x4){0u, 0u, 0u, 0u};
        if (pos > 0) vp = *(const u32x4*)(V + o - DM);
        if (pos < len - 1) vn = *(const u32x4*)(V + o + DM);
        const f32x4 w0a = *(const f32x4*)(cw + c), w0b = *(const f32x4*)(cw + c + 4), w1a = *(const f32x4*)(cw + DM + c), w1b = *(const f32x4*)(cw + DM + c + 4), w2a = *(const f32x4*)(cw + 2 * DM + c), w2b = *(const f32x4*)(cw + 2 * DM + c + 4);
        float w0[8], w1[8], w2[8];
#pragma unroll
        for (int e = 0; e < 4; ++e) { w0[e] = w0a[e]; w0[e + 4] = w0b[e]; w1[e] = w1a[e]; w1[e + 4] = w1b[e]; w2[e] = w2a[e]; w2[e + 4] = w2b[e]; }
        f32x4 ya, yb;
#pragma unroll
        for (int k = 0; k < 4; ++k) {
            const float lo = bf_lo(gb[k]) * (w0[2 * k] * bf_lo(vp[k]) + w1[2 * k] * bf_lo(vc[k]) + w2[2 * k] * bf_lo(vn[k]));
            const float hi = bf_hi(gb[k]) * (w0[2 * k + 1] * bf_hi(vp[k]) + w1[2 * k + 1] * bf_hi(vc[k]) + w2[2 * k + 1] * bf_hi(vn[k]));
            if (k < 2) { ya[2 * k] = lo; ya[2 * k + 1] = hi; } else { yb[2 * k - 4] = lo; yb[2 * k - 3] = hi; }
        }
        *(u32x4*)(Y + o) = pack8(ya, yb);
    }
}

__device__ __forceinline__ void tr_tile(LAS float* tl, const float* src, int ldsrc, bf16_t* dst, int K, int k0, const int tid) {
#pragma unroll
    for (int i = 0; i < 8; ++i) { const int kr = (tid >> 6) + 8 * i, cc = tid & 63; tl[kr * 65 + cc] = src[(size_t)(k0 + kr) * ldsrc + cc]; }
    __syncthreads();
    { const int jr = tid >> 3, kg = (tid & 7) * 8; f32x4 a, b;
#pragma unroll
      for (int q = 0; q < 4; ++q) { a[q] = tl[(kg + q) * 65 + jr]; b[q] = tl[(kg + 4 + q) * 65 + jr]; }
      *(u32x4*)(dst + (size_t)jr * K + k0 + kg) = pack8(a, b); }
    __syncthreads();
}

__device__ __forceinline__ void prep_phase(const Args& a, LAS unsigned char* lds, const int tid, const int cid) {
    unsigned char* ws = a.ws;
    const size_t gtid = (size_t)cid * 512 + tid, gsz = (size_t)gridDim.x * 512;
    const float* xp = a.in[0]; const float* xs = a.in[1];
    { bf16_t* xb = (bf16_t*)(ws + WS_R + R_XB);
      for (size_t it = gtid; it < (size_t)T * 128; it += gsz) { const size_t t = it >> 7; const int c = (int)(it & 127) * 8;
          const float* s = t < (size_t)TP ? xp + t * DM + c : xs + (t - TP) * DM + c;
          *(u32x4*)(xb + t * DM + c) = pack8(*(const f32x4*)s, *(const f32x4*)(s + 4)); } }
    { f32x2* st = (f32x2*)(ws + WS_STATS); for (size_t i = gtid; i < (size_t)T; i += gsz) st[i] = (f32x2){0.f, 1.f};
      if (gtid < 1024) { ((float*)(ws + WS_ONES))[gtid] = 1.0f; ((float*)(ws + WS_ZEROS))[gtid] = 0.0f; } }
    { float* pc = (float*)(ws + WS_TWPC); float* ps = (float*)(ws + WS_TWPS); float* sc = (float*)(ws + WS_TWSC); float* ss = (float*)(ws + WS_TWSS);
      for (size_t i = gtid; i < 16384; i += gsz) { const int k1 = (int)(i >> 7), n2 = (int)(i & 127); float s_, c_; sincospif((float)(k1 * n2) * (1.0f / 8192.0f), &s_, &c_); pc[i] = c_; ps[i] = s_; }
      for (size_t i = gtid; i < 8192; i += gsz) { const int k1 = (int)(i >> 6), n2 = (int)(i & 63); float s_, c_; sincospif((float)(k1 * n2) * (1.0f / 4096.0f), &s_, &c_); sc[i] = c_; ss[i] = s_; } }
    { bf16_t* F1 = (bf16_t*)(ws + WS_F1); bf16_t* F3p = (bf16_t*)(ws + WS_F3P); bf16_t* F3s = (bf16_t*)(ws + WS_F3S);
      const float is128 = 0.08838834764831845f, is64 = 0.125f;
      for (size_t i = gtid; i < 65536; i += gsz) {
          const int r = (int)(i >> 8), k = (int)(i & 255);
          { const int ro = r >> 7, k1 = r & 127, ri = k >> 7, n1 = k & 127; float s_, c_; sincospif((float)((k1 * n1) & 127) * (1.0f / 64.0f), &s_, &c_);
            const float v = (ro == ri) ? c_ : (ro == 0 ? s_ : -s_); F1[i] = (bf16_t)(cvt_pk_bf16(v * is128, 0.f) & 0xffffu); }
          { float v = 0.f; if (r < 128) { const int ri = k >> 7, n2 = k & 127; float s_, c_; sincospif((float)((r * n2) & 127) * (1.0f / 64.0f), &s_, &c_); v = (ri == 0 ? c_ : s_) * is128; }
            F3p[i] = (bf16_t)(cvt_pk_bf16(v, 0.f) & 0xffffu); }
          { float v = 0.f; if (r < 128) { const int clo_r = r >> 6, k2 = r & 63, clo_k = k >> 7, ri = (k >> 6) & 1, n2 = k & 63;
                if (clo_r == clo_k) { float s_, c_; sincospif((float)((k2 * n2) & 63) * (1.0f / 32.0f), &s_, &c_); v = (ri == 0 ? c_ : s_) * is64; } }
            F3s[i] = (bf16_t)(cvt_pk_bf16(v, 0.f) & 0xffffu); }
      } }
    { LAS float* tab = (LAS float*)lds;
      if (tid < 128) tab[tid] = cospif((float)tid * (1.0f / 64.0f));
      __syncthreads();
      const float* win = a.in[7]; bf16_t* Wy = (bf16_t*)(ws + WS_WY);
      for (size_t o = gtid; o < (size_t)2048 * 1024; o += gsz) {
          const int c = (int)(o & 1023), ri = (int)(o >> 10) & 1, d = (int)(o >> 11), g = c >> 7, kc = c & 127;
          const float* wr_ = win + (size_t)d * 1024 + g * 128; float s = 0.f;
          const int ph0 = ri ? 32 : 0;
          for (int cp = 0; cp < 128; ++cp) s += wr_[cp] * tab[(cp * kc + ph0) & 127];
          Wy[(size_t)(ri * 1024 + c) * 1024 + d] = (bf16_t)(cvt_pk_bf16(s * 0.08838834764831845f, 0.f) & 0xffffu);
      }
      __syncthreads(); }
    { LAS float* tl = (LAS float*)lds;
      const int NT_GU = 4 * 88 * 16, NT_WD = 4 * 16 * 44, NT_FO = 256, NT_CI = 48 * 16, NT_CO = 256, NT_ALL = NT_GU + NT_WD + NT_FO + NT_CI + NT_CO;
      for (int tix = cid; tix < NT_ALL; tix += gridDim.x) {
          int x = tix;
          if (x < NT_GU) { const int lf = x / (88 * 16), r = x % (88 * 16), jt = r / 16, kt = r % 16, j0 = jt * 64, pn = j0 >> 8, jj = j0 & 255;
              const float* src = (jj < 128 ? a.in[2] : a.in[3]) + (size_t)lf * DM * DFF + pn * 128 + (jj & 127);
              tr_tile(tl, src, DFF, (bf16_t*)(ws + WS_WGU) + (size_t)lf * 5632 * 1024 + (size_t)j0 * 1024, 1024, kt * 64, tid); continue; }
          x -= NT_GU;
          if (x < NT_WD) { const int lf = x / (16 * 44), r = x % (16 * 44), jt = r / 44, kt = r % 44, j0 = jt * 64;
              tr_tile(tl, a.in[4] + (size_t)lf * DFF * DM + j0, DM, (bf16_t*)(ws + WS_WD) + (size_t)lf * 1024 * 2816 + (size_t)j0 * 2816, 2816, kt * 64, tid); continue; }
          x -= NT_WD;
          if (x < NT_FO) { const int jt = x / 16, kt = x % 16, j0 = jt * 64; tr_tile(tl, a.in[8] + j0, DM, (bf16_t*)(ws + WS_WFO) + (size_t)j0 * 1024, 1024, kt * 64, tid); continue; }
          x -= NT_FO;
          if (x < NT_CI) { const int jt = x / 16, kt = x % 16, j0 = jt * 64, pn = j0 >> 8, jj = j0 & 255;
              const int col = pn < 8 ? (jj < 128 ? 1024 + pn * 128 + jj : 2048 + pn * 128 + (jj - 128)) : (pn - 8) * 256 + jj;
              tr_tile(tl, a.in[9] + col, 3072, (bf16_t*)(ws + WS_WCI) + (size_t)j0 * 1024, 1024, kt * 64, tid); continue; }
          x -= NT_CI;
          { const int jt = x / 16, kt = x % 16, j0 = jt * 64; tr_tile(tl, a.in[11] + j0, DM, (bf16_t*)(ws + WS_WCO) + (size_t)j0 * 1024, 1024, kt * 64, tid); }
      } }
}

template <bool COOP>
__global__ void __launch_bounds__(512, 2) fwd(Args a) {
    extern __shared__ __attribute__((aligned(16))) unsigned char lds_raw[];
    LAS unsigned char* lds = (LAS unsigned char*)lds_raw;
    unsigned char* ws = a.ws;
    bf16_t* R = (bf16_t*)(ws + WS_R);
    bf16_t* const XB = (bf16_t*)(ws + WS_R + R_XB); bf16_t* const HB = (bf16_t*)(ws + WS_R + R_H);
    bf16_t* const DB = (bf16_t*)(ws + WS_R + R_D); bf16_t* const EB = (bf16_t*)(ws + WS_R + R_E); bf16_t* const FB = (bf16_t*)(ws + WS_R + R_F);
    bf16_t* const VB = (bf16_t*)(ws + WS_R + R_V); bf16_t* const GB = (bf16_t*)(ws + WS_R + R_G); bf16_t* const YB = (bf16_t*)(ws + WS_R + R_Y);
    (void)R;
    f32x2* const stats = (f32x2*)(ws + WS_STATS);
    const float* const ones = (const float*)(ws + WS_ONES); const float* const zeros = (const float*)(ws + WS_ZEROS);
    const float* const lng = a.in[5]; const float* const lnb = a.in[6];
    const int G = (int)gridDim.x;

#pragma unroll 1
#ifdef REP_MASK
    for (int e_ = 2 * a.ph_lo; e_ < 2 * a.ph_hi; ++e_) {
        const int ph = e_ >> 1;
        if ((e_ & 1) && !(((REP_MASK) >> ph) & 1)) continue;
#else
    for (int ph = a.ph_lo; ph < a.ph_hi; ++ph) {
#endif
        int tid = threadIdx.x, cid = blockIdx.x;
        asm volatile("" : "+v"(tid), "+s"(cid));
        int kind, p0 = 0, p1 = 0;
        switch (ph) {
            case 0: kind = 0; break;
            case 1: kind = 1; p0 = 0; break;
            case 2: kind = 2; p0 = 0; p1 = -1; break;
            case 3: kind = 3; p0 = 0; p1 = 1; break;
            case 4: kind = 4; break;
            case 5: kind = 5; break;
            case 6: kind = 6; break;
            case 7: kind = 2; p0 = 4; p1 = 0; break;
            case 8: kind = 3; p0 = 1; break;
            case 9: kind = 1; p0 = 1; break;
            case 10: kind = 2; p0 = 1; p1 = 1; break;
            case 11: kind = 3; p0 = 2; break;
            case 12: kind = 1; p0 = 2; break;
            case 13: kind = 2; p0 = 2; p1 = 2; break;
            case 14: kind = 3; p0 = 3; break;
            case 15: kind = 7; break;
            case 16: kind = 8; break;
            case 17: kind = 2; p0 = 5; p1 = 3; break;
            case 18: kind = 3; p0 = 4; break;
            case 19: kind = 1; p0 = 3; break;
            case 20: kind = 2; p0 = 3; p1 = 4; break;
            default: kind = 3; p0 = 5; p1 = 2; break;
        }
#ifdef ONLY_KIND
        kind = ONLY_KIND;
#endif
        if (kind == 0) {
            prep_phase(a, lds, tid, cid);
        } else if (kind == 1) {
            pg8::Gemm g{XB, (const bf16_t*)(ws + WS_WGU) + (size_t)p0 * 5632 * 1024, T, 5632, 1024};
            pg8::StaticOrder S; S.init(g.M, g.N, G, cid);
            EpiGU E{HB};
            pg8::gemm_phase<EpiGU>(lds, g, S, E, tid);
        } else if (kind == 2) {
            pg8::Gemm g;
            float scale;
            if (p0 < 4) { g = pg8::Gemm{HB, (const bf16_t*)(ws + WS_WD) + (size_t)p0 * 1024 * 2816, T, 1024, 2816}; scale = 0.5f; }
            else if (p0 == 4) { g = pg8::Gemm{FB, (const bf16_t*)(ws + WS_WFO), T, 1024, 1024}; scale = 1.0f; }
            else { g = pg8::Gemm{YB, (const bf16_t*)(ws + WS_WCO), T, 1024, 1024}; scale = 1.0f; }
            pg8::StaticOrder S; S.init(g.M, g.N, G, cid);
            EpiRes E;
            if (p1 < 0) { E.zin0 = a.in[0]; E.zin1 = a.in[1]; E.gam = ones; E.bet = zeros; }
            else { E.zin0 = a.out; E.zin1 = a.out + (size_t)TP * DM; E.gam = lng + p1 * DM; E.bet = lnb + p1 * DM; }
            E.zout = a.out; E.stats = stats; E.scale = scale;
            pg8::gemm_phase<EpiRes>(lds, g, S, E, tid);
        } else if (kind == 3) {
            ln_pass(a.out, stats, lng + p0 * DM, lnb + p0 * DM, XB, p1 == 1, p1 == 2, tid, cid);
        } else if (kind == 4) {
            pg8::Gemm g{(const bf16_t*)(ws + WS_WY), XB, 2048, T, 1024};
            pg8::StaticOrder S; S.init(g.M, g.N, G, cid);
            EpiD E{DB};
            pg8::gemm_phase<EpiD>(lds, g, S, E, tid);
        } else if (kind == 5) {
            pg8::Gemm g{(const bf16_t*)(ws + WS_F1), DB, 256, 786432, 256};
            pg8::StaticOrder S; S.init(g.M, g.N, G, cid);
            EpiB1 E{EB, (const float*)(ws + WS_TWPC), (const float*)(ws + WS_TWPS), (const float*)(ws + WS_TWSC), (const float*)(ws + WS_TWSS)};
            pg8::gemm_phase<EpiB1>(lds, g, S, E, tid);
        } else if (kind == 6) {
#pragma unroll 1
            for (int s = 0; s < 2; ++s) {
                pg8::Gemm g{(const bf16_t*)(ws + (s ? WS_F3S : WS_F3P)), EB + (s ? ES_BASE : 0), 256, s ? 524288 : 262144, 256};
                pg8::StaticOrder S; S.init(g.M, g.N, G, cid);
                EpiB3 E{FB, s};
                pg8::gemm_phase<EpiB3>(lds, g, S, E, tid);
            }
        } else if (kind == 7) {
            pg8::Gemm g{XB, (const bf16_t*)(ws + WS_WCI), T, 3072, 1024};
            pg8::StaticOrder S; S.init(g.M, g.N, G, cid);
            EpiCI E{VB, GB};
            pg8::gemm_phase<EpiCI>(lds, g, S, E, tid);
        } else {
            conv_pass(VB, GB, a.in[10], YB, tid, cid);
        }
#ifdef REP_MASK
        if (e_ + 1 < 2 * a.ph_hi) { if constexpr (COOP) cg::this_grid().sync(); }
#else
        if (ph + 1 < a.ph_hi) { if constexpr (COOP) cg::this_grid().sync(); }
#endif
    }
}

extern "C" void kernel_launch(void* const* d_in, const int* in_sizes, int n_in, void* d_out, int out_size, void* d_ws, size_t ws_size, hipStream_t stream) {
    static int grid = 0;
    constexpr int LDS_BYTES = pg8::STAGE_BYTES + 16384;
    if (grid == 0) {
        if (n_in != 12 || out_size != T * DM || ws_size < WS_END) { fprintf(stderr, "kernel_launch: unexpected shapes (n_in %d out %d ws %zu, need %zu)\n", n_in, out_size, ws_size, (size_t)WS_END); grid = -1; return; }
        int dev = 0, cus = 0, per_cu = 0;
        hipGetDevice(&dev); hipDeviceGetAttribute(&cus, hipDeviceAttributeMultiprocessorCount, dev);
        hipFuncSetAttribute((const void*)fwd<true>, hipFuncAttributeMaxDynamicSharedMemorySize, LDS_BYTES);
        hipFuncSetAttribute((const void*)fwd<false>, hipFuncAttributeMaxDynamicSharedMemorySize, LDS_BYTES);
        hipOccupancyMaxActiveBlocksPerMultiprocessor(&per_cu, (const void*)fwd<true>, 512, LDS_BYTES);
        (void)hipGetLastError();
        if (per_cu < 1) per_cu = 1;
        grid = cus;
        fprintf(stderr, "kernel_launch: cus %d per_cu %d grid %d\n", cus, per_cu, grid);
    }
    if (grid < 0) return;
    Args a{};
    for (int i = 0; i < 12; ++i) a.in[i] = (const float*)d_in[i];
    a.out = (float*)d_out; a.ws = (unsigned char*)d_ws;
#if MK_COOP
    a.ph_lo = 0; a.ph_hi = NPH;
    void* args[] = {&a};
    hipError_t e = hipLaunchCooperativeKernel((const void*)fwd<true>, dim3(grid), dim3(512), args, LDS_BYTES, stream);
    if (e != hipSuccess) fprintf(stderr, "cooperative launch failed: %s\n", hipGetErrorString(e));
#else
    for (int ph = 0; ph < NPH; ++ph) { a.ph_lo = ph; a.ph_hi = ph + 1; hipLaunchKernelGGL(fwd<false>, dim3(grid), dim3(512), LDS_BYTES, stream, a); }
#endif
}
```
